# Optimizing an MI355X kernel written in HIP

```python
import math
import jax, jax.numpy as jnp
from jax import lax
import numpy as np

D_MODEL = 1024
BATCH = 4
SEQ = 4096
DEPTH = 2

MLA_HEADS = 8
MLA_Q_LORA = 256
MLA_KV_LORA = 128
MLA_NOPE = 64
MLA_ROPE = 32
MLA_V = 64
MLA_WIDTH = MLA_HEADS * MLA_V
DIFF_HEADS = 4
DIFF_HEAD_DIM = 64
DIFF_WIDTH = DIFF_HEADS * 2 * DIFF_HEAD_DIM
DIFF_ROT = DIFF_HEAD_DIM // 4
ROPE_THETA = 500000.0
Q_BLOCK = 128
DEEPNORM_ALPHA = (2 * DEPTH) ** 0.25
DEEPNORM_BETA = (8 * DEPTH) ** -0.25
LN_EPS = 1e-5
RMS_EPS = 1e-6
IN_SPLITS = (MLA_Q_LORA, MLA_KV_LORA, MLA_ROPE, MLA_WIDTH,
             DIFF_WIDTH, DIFF_WIDTH, DIFF_WIDTH, DIFF_WIDTH, 2 * D_MODEL)
IN_COLS = sum(IN_SPLITS)

kernel_name = "hybrid_mla_diffattn_gated_deepnorm"


def _rms_norm(x, g, eps=RMS_EPS):
    xf = x.astype(jnp.float32)
    y = xf * lax.rsqrt(jnp.mean(xf * xf, axis=-1, keepdims=True) + eps)
    return (y * g.astype(jnp.float32)).astype(x.dtype)


def _layer_norm(x, g, b, eps=LN_EPS):
    xf = x.astype(jnp.float32)
    mu = jnp.mean(xf, axis=-1, keepdims=True)
    var = jnp.mean(jnp.square(xf - mu), axis=-1, keepdims=True)
    y = (xf - mu) * lax.rsqrt(var + eps)
    return (y * g.astype(jnp.float32) + b.astype(jnp.float32)).astype(x.dtype)


def _rotary(x, rot_dim):
    seq = x.shape[1]
    half = rot_dim // 2
    inv_freq = ROPE_THETA ** (-jnp.arange(half, dtype=jnp.float32) / half)
    ang = jnp.arange(seq, dtype=jnp.float32)[:, None] * inv_freq[None, :]
    shape = (seq,) + (1,) * (x.ndim - 3) + (half,)
    cos = jnp.cos(ang).reshape(shape)
    sin = jnp.sin(ang).reshape(shape)
    xr = x[..., :rot_dim].astype(jnp.float32)
    x1, x2 = xr[..., :half], xr[..., half:]
    rot = jnp.concatenate([x1 * cos - x2 * sin, x2 * cos + x1 * sin], axis=-1).astype(x.dtype)
    return jnp.concatenate([rot, x[..., rot_dim:]], axis=-1)


def _split_cols(h):
    parts, start = [], 0
    for size in IN_SPLITS:
        parts.append(h[..., start:start + size])
        start += size
    return parts


def _dense_attention(q, k, v, scale):
    b, h, s, dk = q.shape
    nb = s // Q_BLOCK
    qb = q.reshape(b, h, nb, Q_BLOCK, dk).transpose(2, 0, 1, 3, 4)

    def one_block(q_blk):
        sc = jnp.einsum('bhqd,bhkd->bhqk', q_blk, k, preferred_element_type=jnp.float32) * scale
        p = jax.nn.softmax(sc, axis=-1).astype(v.dtype)
        return jnp.einsum('bhqk,bhkd->bhqd', p, v)

    o = lax.map(one_block, qb)
    return o.transpose(1, 2, 0, 3, 4).reshape(b, h, s, v.shape[-1])


def _differential_attention(q, k, v, lam, scale):
    b, h, two, s, d = q.shape
    nb = s // Q_BLOCK
    qb = q.reshape(b, h, two, nb, Q_BLOCK, d).transpose(3, 0, 1, 2, 4, 5)

    def one_block(q_blk):
        sc = jnp.einsum('bhmqd,bhmkd->bhmqk', q_blk, k, preferred_element_type=jnp.float32) * scale
        p = jax.nn.softmax(sc, axis=-1)
        p_diff = (p[:, :, 0] - lam * p[:, :, 1]).astype(v.dtype)
        return jnp.einsum('bhqk,bhkd->bhqd', p_diff, v)

    o = lax.map(one_block, qb)
    return o.transpose(1, 2, 0, 3, 4).reshape(b, h, s, v.shape[-1])


def setup_inputs(seed: int = 0) -> dict:
    key = jax.random.key(seed)
    ks = jax.random.split(key, 16)
    f32 = jnp.float32

    def nrm(k, shape, scale):
        return jax.random.normal(k, shape, f32) * scale

    return {
        "x": jax.random.normal(ks[0], (BATCH, SEQ, D_MODEL), f32),
        "w_in": nrm(ks[1], (DEPTH, D_MODEL, IN_COLS), D_MODEL ** -0.5),
        "g_q": 1.0 + nrm(ks[2], (DEPTH, MLA_Q_LORA), 0.02),
        "w_q_up": nrm(ks[3], (DEPTH, MLA_Q_LORA, MLA_HEADS * (MLA_NOPE + MLA_ROPE)), MLA_Q_LORA ** -0.5),
        "g_kv": 1.0 + nrm(ks[4], (DEPTH, MLA_KV_LORA), 0.02),
        "w_kv_up": nrm(ks[5], (DEPTH, MLA_KV_LORA, MLA_HEADS * (MLA_NOPE + MLA_V)), MLA_KV_LORA ** -0.5),
        "diff_lambda": nrm(ks[6], (DEPTH, 4, DIFF_HEAD_DIM), 0.1),
        "g_diff": 1.0 + nrm(ks[7], (DEPTH, 2 * DIFF_HEAD_DIM), 0.02),
        "w_branch_a": nrm(ks[8], (DEPTH, MLA_WIDTH, D_MODEL), MLA_WIDTH ** -0.5),
        "w_branch_b": nrm(ks[9], (DEPTH, DIFF_WIDTH, D_MODEL), DIFF_WIDTH ** -0.5),
        "b_merge": nrm(ks[10], (DEPTH, 2 * D_MODEL), 0.02),
        "w_out": nrm(ks[11], (DEPTH, D_MODEL, D_MODEL), D_MODEL ** -0.5 * DEEPNORM_BETA),
        "ln_gamma": 1.0 + nrm(ks[12], (DEPTH, D_MODEL), 0.02),
        "ln_beta": nrm(ks[13], (DEPTH, D_MODEL), 0.02),
    }


def reference(x, w_in, g_q, w_q_up, g_kv, w_kv_up, diff_lambda, g_diff,
              w_branch_a, w_branch_b, b_merge, w_out, ln_gamma, ln_beta):
    b, s, _ = x.shape
    mla_scale = 1.0 / math.sqrt(MLA_NOPE + MLA_ROPE)
    diff_scale = 1.0 / math.sqrt(DIFF_HEAD_DIM)
    for l in range(DEPTH):
        h = x @ w_in[l]
        c_q, c_kv, k_r, gate_a, q_d, k_d, v_d, gate_b, gates = _split_cols(h)

        q_a = (_rms_norm(c_q, g_q[l]) @ w_q_up[l]).reshape(b, s, MLA_HEADS, MLA_NOPE + MLA_ROPE)
        q_a = jnp.concatenate([q_a[..., :MLA_NOPE], _rotary(q_a[..., MLA_NOPE:], MLA_ROPE)], axis=-1)
        kv = (_rms_norm(c_kv, g_kv[l]) @ w_kv_up[l]).reshape(b, s, MLA_HEADS, MLA_NOPE + MLA_V)
        k_rope = _rotary(k_r, MLA_ROPE)
        k_a = jnp.concatenate(
            [kv[..., :MLA_NOPE], jnp.broadcast_to(k_rope[:, :, None, :], (b, s, MLA_HEADS, MLA_ROPE))], axis=-1)
        v_a = kv[..., MLA_NOPE:]
        o_a = _dense_attention(q_a.transpose(0, 2, 1, 3), k_a.transpose(0, 2, 1, 3),
                               v_a.transpose(0, 2, 1, 3), mla_scale)
        y_a = o_a.transpose(0, 2, 1, 3).reshape(b, s, MLA_WIDTH) * jax.nn.silu(gate_a)
        y_a = y_a @ w_branch_a[l]

        q_b = _rotary(q_d.reshape(b, s, DIFF_HEADS, 2, DIFF_HEAD_DIM), DIFF_ROT)
        k_b = _rotary(k_d.reshape(b, s, DIFF_HEADS, 2, DIFF_HEAD_DIM), DIFF_ROT)
        v_b = v_d.reshape(b, s, DIFF_HEADS, 2 * DIFF_HEAD_DIM)
        lam_init = 0.8 - 0.6 * math.exp(-0.3 * l)
        lp = diff_lambda[l].astype(jnp.float32)
        lam = jnp.exp(jnp.sum(lp[0] * lp[1])) - jnp.exp(jnp.sum(lp[2] * lp[3])) + lam_init
        o_b = _differential_attention(q_b.transpose(0, 2, 3, 1, 4), k_b.transpose(0, 2, 3, 1, 4),
                                      v_b.transpose(0, 2, 1, 3), lam, diff_scale)
        o_b = _rms_norm(o_b, g_diff[l], eps=1e-5) * (1.0 - lam_init)
        y_b = o_b.transpose(0, 2, 1, 3).reshape(b, s, DIFF_WIDTH) * jax.nn.silu(gate_b)
        y_b = y_b @ w_branch_b[l]

        g = jax.nn.sigmoid(gates + b_merge[l])
        merged = g[..., :D_MODEL] * y_a + g[..., D_MODEL:] * y_b
        out = merged @ w_out[l]
        x = _layer_norm(DEEPNORM_ALPHA * x + out, ln_gamma[l], ln_beta[l])
    return x
```

```cpp
#include <hip/hip_runtime.h>
#include <cstdio>
#include <cmath>

namespace nv {
constexpr int D = 1024, NB = 4, S = 4096, DEPTH = 2, INC = 5024;
constexpr int C_CQ = 0, C_CKV = 256, C_KR = 384, C_GA = 416, C_QD = 928, C_KD = 1440, C_VD = 1952, C_GB = 2464, C_G = 2976;
constexpr float ALPHA = 1.41421356237309515f;

__global__ __launch_bounds__(256) void gemm_nn(const float* __restrict__ A, int lda, const float* __restrict__ Bm, int ldb, float* __restrict__ C, int ldc, int M, int N, int K) {
    __shared__ float As[16][68];
    __shared__ float Bs[16][68];
    const int tid = threadIdx.x, tx = tid & 15, ty = tid >> 4;
    const int m0 = blockIdx.y * 64, n0 = blockIdx.x * 64;
    float acc[4][4] = {};
    for (int k0 = 0; k0 < K; k0 += 16) {
        {
            const int r = tid >> 2, kk = (tid & 3) * 4;
            const float4 a = *(const float4*)(A + (size_t)(m0 + r) * lda + k0 + kk);
            As[kk + 0][r] = a.x; As[kk + 1][r] = a.y; As[kk + 2][r] = a.z; As[kk + 3][r] = a.w;
        }
        {
            const int kk = tid >> 4, nn = (tid & 15) * 4;
#pragma unroll
            for (int j = 0; j < 4; ++j) { const int n = n0 + nn + j; Bs[kk][nn + j] = (n < N) ? Bm[(size_t)(k0 + kk) * ldb + n] : 0.f; }
        }
        __syncthreads();
#pragma unroll
        for (int kk = 0; kk < 16; ++kk) {
            const float4 a = *(const float4*)&As[kk][ty * 4];
            const float4 b = *(const float4*)&Bs[kk][tx * 4];
            const float av[4] = {a.x, a.y, a.z, a.w}, bv[4] = {b.x, b.y, b.z, b.w};
#pragma unroll
            for (int i = 0; i < 4; ++i)
#pragma unroll
                for (int j = 0; j < 4; ++j) acc[i][j] = fmaf(av[i], bv[j], acc[i][j]);
        }
        __syncthreads();
    }
#pragma unroll
    for (int i = 0; i < 4; ++i)
#pragma unroll
        for (int j = 0; j < 4; ++j) { const int n = n0 + tx * 4 + j; if (n < N) C[(size_t)(m0 + ty * 4 + i) * ldc + n] = acc[i][j]; }
}

__global__ __launch_bounds__(64) void rms_rows(const float* __restrict__ x, int ldx, int L, const float* __restrict__ g, float eps, float* __restrict__ out, int ldo) {
    const int row = blockIdx.x, lane = threadIdx.x;
    float ss = 0.f;
    for (int j = lane; j < L; j += 64) { const float v = x[(size_t)row * ldx + j]; ss += v * v; }
    for (int o = 32; o > 0; o >>= 1) ss += __shfl_xor(ss, o);
    const float r = 1.0f / sqrtf(ss / (float)L + eps);
    for (int j = lane; j < L; j += 64) out[(size_t)row * ldo + j] = x[(size_t)row * ldx + j] * r * g[j];
}

__global__ __launch_bounds__(64) void rotary(float* __restrict__ x, int ldx, int nvec, int vstride, int rot) {
    const int row = blockIdx.x, half = rot / 2; const int pos = row % S;
    for (int idx = threadIdx.x; idx < nvec * half; idx += 64) {
        const int v = idx / half, i = idx % half;
        const float inv_freq = (float)pow(500000.0, -(double)i / (double)half);
        const float ang = (float)pos * inv_freq;
        const float c = (float)cos((double)ang), s = (float)sin((double)ang);
        float* p = x + (size_t)row * ldx + v * vstride;
        const float x1 = p[i], x2 = p[i + half];
        p[i] = x1 * c - x2 * s; p[i + half] = x2 * c + x1 * s;
    }
}

template <int DK1, int DK2, int DV>
__global__ __launch_bounds__(64) void attn_naive(const float* __restrict__ q, int ldq, const float* __restrict__ k1, int ldk1, const float* __restrict__ k2, int ldk2,
                                                 const float* __restrict__ v, int ldv, float* __restrict__ out, int ldo, float scale, int nkeys) {
    constexpr int DK = DK1 + DK2, KT = 32;
    __shared__ float Ks[KT][DK];
    __shared__ float Vs[KT][DV];
    const int lane = threadIdx.x, row = blockIdx.x * 64 + lane;
    float qr[DK], o[DV];
#pragma unroll
    for (int d = 0; d < DK; ++d) qr[d] = q[(size_t)row * ldq + d] * scale;
#pragma unroll
    for (int d = 0; d < DV; ++d) o[d] = 0.f;
    float m = -1e30f, l = 0.f;
    for (int kt = 0; kt < nkeys; kt += KT) {
        __syncthreads();
        for (int idx = lane; idx < KT * DK1; idx += 64) { const int kk = idx / DK1, d = idx % DK1; Ks[kk][d] = k1[(size_t)(kt + kk) * ldk1 + d]; }
        if (DK2 > 0) for (int idx = lane; idx < KT * DK2; idx += 64) { const int kk = idx / (DK2 > 0 ? DK2 : 1), d = idx % (DK2 > 0 ? DK2 : 1); Ks[kk][DK1 + d] = k2[(size_t)(kt + kk) * ldk2 + d]; }
        for (int idx = lane; idx < KT * DV; idx += 64) { const int kk = idx / DV, d = idx % DV; Vs[kk][d] = v[(size_t)(kt + kk) * ldv + d]; }
        __syncthreads();
        float s[KT]; float tm = -1e30f;
#pragma unroll
        for (int kk = 0; kk < KT; ++kk) {
            float a = 0.f;
#pragma unroll
            for (int d = 0; d < DK; ++d) a = fmaf(qr[d], Ks[kk][d], a);
            s[kk] = a; tm = fmaxf(tm, a);
        }
        const float mn = fmaxf(m, tm), alpha = __expf(m - mn);
        m = mn; l *= alpha;
#pragma unroll
        for (int d = 0; d < DV; ++d) o[d] *= alpha;
#pragma unroll
        for (int kk = 0; kk < KT; ++kk) {
            const float p = __expf(s[kk] - mn); l += p;
#pragma unroll
            for (int d = 0; d < DV; ++d) o[d] = fmaf(p, Vs[kk][d], o[d]);
        }
    }
    const float rl = 1.0f / l;
#pragma unroll
    for (int d = 0; d < DV; ++d) out[(size_t)row * ldo + d] = o[d] * rl;
}

__device__ __forceinline__ float silu_f(float x) { return x / (1.0f + expf(-x)); }
__device__ __forceinline__ float sigm_f(float x) { return 1.0f / (1.0f + expf(-x)); }

__global__ __launch_bounds__(256) void mul_silu(const float* __restrict__ oa, const float* __restrict__ h, int gcol, float* __restrict__ out, int rows) {
    const size_t i = (size_t)blockIdx.x * 256 + threadIdx.x; if (i >= (size_t)rows * 512) return;
    const int row = (int)(i / 512), c = (int)(i % 512);
    out[i] = oa[i] * silu_f(h[(size_t)row * INC + gcol + c]);
}
__global__ __launch_bounds__(64) void diff_combine(const float* __restrict__ o1, const float* __restrict__ o2, const float* __restrict__ lamp, const float* __restrict__ gdiff,
                                                   const float* __restrict__ h, float lam_init, float* __restrict__ out) {
    const int row = blockIdx.x >> 2, hd = blockIdx.x & 3, lane = threadIdx.x;
    float a = lamp[lane] * lamp[64 + lane], b = lamp[128 + lane] * lamp[192 + lane];
    for (int o = 32; o > 0; o >>= 1) { a += __shfl_xor(a, o); b += __shfl_xor(b, o); }
    const float lam = expf(a) - expf(b) + lam_init;
    const size_t base = (size_t)row * 512 + hd * 128;
    const float d0 = o1[base + lane] - lam * o2[base + lane], d1 = o1[base + 64 + lane] - lam * o2[base + 64 + lane];
    float ss = d0 * d0 + d1 * d1;
    for (int o = 32; o > 0; o >>= 1) ss += __shfl_xor(ss, o);
    const float r = 1.0f / sqrtf(ss / 128.f + 1e-5f) * (1.0f - lam_init);
    const float* gb = h + (size_t)row * INC + C_GB + hd * 128;
    out[base + lane] = d0 * r * gdiff[lane] * silu_f(gb[lane]);
    out[base + 64 + lane] = d1 * r * gdiff[64 + lane] * silu_f(gb[64 + lane]);
}
__global__ __launch_bounds__(256) void merge_k(const float* __restrict__ ya, const float* __restrict__ yb, const float* __restrict__ h, const float* __restrict__ bm, float* __restrict__ out, int rows) {
    const size_t i = (size_t)blockIdx.x * 256 + threadIdx.x; if (i >= (size_t)rows * 1024) return;
    const int row = (int)(i / 1024), c = (int)(i % 1024);
    const float* g = h + (size_t)row * INC + C_G;
    out[i] = sigm_f(g[c] + bm[c]) * ya[i] + sigm_f(g[1024 + c] + bm[1024 + c]) * yb[i];
}
__global__ __launch_bounds__(256) void ln_res(const float* xin, const float* __restrict__ o, const float* __restrict__ gamma, const float* __restrict__ beta, float* xout) {
    __shared__ float red[4];
    const int row = blockIdx.x, tid = threadIdx.x;
    float v[4]; float s = 0.f;
#pragma unroll
    for (int j = 0; j < 4; ++j) { const int c = tid + 256 * j; v[j] = ALPHA * xin[(size_t)row * D + c] + o[(size_t)row * D + c]; s += v[j]; }
    for (int of = 32; of > 0; of >>= 1) s += __shfl_xor(s, of);
    if ((tid & 63) == 0) red[tid >> 6] = s;
    __syncthreads();
    const float mean = (red[0] + red[1] + red[2] + red[3]) / (float)D;
    __syncthreads();
    float q = 0.f;
#pragma unroll
    for (int j = 0; j < 4; ++j) { v[j] -= mean; q += v[j] * v[j]; }
    for (int of = 32; of > 0; of >>= 1) q += __shfl_xor(q, of);
    if ((tid & 63) == 0) red[tid >> 6] = q;
    __syncthreads();
    const float rstd = 1.0f / sqrtf((red[0] + red[1] + red[2] + red[3]) / (float)D + 1e-5f);
#pragma unroll
    for (int j = 0; j < 4; ++j) { const int c = tid + 256 * j; xout[(size_t)row * D + c] = v[j] * rstd * gamma[c] + beta[c]; }
}
}

extern "C" void kernel_launch(void* const* d_in, const int* in_sizes, int n_in, void* d_out, int out_size, void* d_ws, size_t ws_size, hipStream_t stream) {
    using namespace nv;
    const float* x = (const float*)d_in[0];      const float* w_in = (const float*)d_in[1];
    const float* g_q = (const float*)d_in[2];    const float* w_q_up = (const float*)d_in[3];
    const float* g_kv = (const float*)d_in[4];   const float* w_kv_up = (const float*)d_in[5];
    const float* dlam = (const float*)d_in[6];   const float* g_diff = (const float*)d_in[7];
    const float* w_ba = (const float*)d_in[8];   const float* w_bb = (const float*)d_in[9];
    const float* b_merge = (const float*)d_in[10]; const float* w_out = (const float*)d_in[11];
    const float* ln_g = (const float*)d_in[12];  const float* ln_b = (const float*)d_in[13];
    float* out = (float*)d_out;
    float* ws = (float*)d_ws; size_t off = 0;
    auto take = [&](size_t n) { float* p = ws + off; off += (n + 63) / 64 * 64; return p; };
    float* H = take((size_t)S * INC);
    float* CQ = take((size_t)S * 256);  float* CKV = take((size_t)S * 128);
    float* QA = take((size_t)S * 768);  float* KV = take((size_t)S * 1024);
    float* OA = take((size_t)S * 512);  float* OB1 = take((size_t)S * 512); float* OB2 = take((size_t)S * 512);
    float* YAIN = take((size_t)S * 512); float* YBIN = take((size_t)S * 512);
    float* YA = take((size_t)S * 1024); float* YB = take((size_t)S * 1024);
    float* MRG = take((size_t)S * 1024); float* OUT = take((size_t)S * 1024);
    if (off * 4 > ws_size) { fprintf(stderr, "workspace too small: need %zu have %zu\n", off * 4, ws_size); return; }
    auto gemm = [&](const float* A, int lda, const float* Bm, int ldb, float* C, int ldc, int M, int N, int K) {
        hipLaunchKernelGGL(gemm_nn, dim3((N + 63) / 64, M / 64), dim3(256), 0, stream, A, lda, Bm, ldb, C, ldc, M, N, K);
    };
    for (int b = 0; b < NB; ++b) {
        for (int l = 0; l < DEPTH; ++l) {
            const float* xin = (l == 0) ? x + (size_t)b * S * D : out + (size_t)b * S * D;
            float* xout = out + (size_t)b * S * D;
            const float lam_init = 0.8f - 0.6f * expf(-0.3f * (float)l);
            gemm(xin, D, w_in + (size_t)l * D * INC, INC, H, INC, S, INC, D);
            hipLaunchKernelGGL(rms_rows, dim3(S), dim3(64), 0, stream, H + C_CQ, INC, 256, g_q + l * 256, 1e-6f, CQ, 256);
            hipLaunchKernelGGL(rms_rows, dim3(S), dim3(64), 0, stream, H + C_CKV, INC, 128, g_kv + l * 128, 1e-6f, CKV, 128);
            gemm(CQ, 256, w_q_up + (size_t)l * 256 * 768, 768, QA, 768, S, 768, 256);
            gemm(CKV, 128, w_kv_up + (size_t)l * 128 * 1024, 1024, KV, 1024, S, 1024, 128);
            hipLaunchKernelGGL(rotary, dim3(S), dim3(64), 0, stream, QA + 64, 768, 8, 96, 32);
            hipLaunchKernelGGL(rotary, dim3(S), dim3(64), 0, stream, H + C_KR, INC, 1, 32, 32);
            hipLaunchKernelGGL(rotary, dim3(S), dim3(64), 0, stream, H + C_QD, INC, 8, 64, 16);
            hipLaunchKernelGGL(rotary, dim3(S), dim3(64), 0, stream, H + C_KD, INC, 8, 64, 16);
            for (int hd = 0; hd < 8; ++hd)
                hipLaunchKernelGGL((attn_naive<64, 32, 64>), dim3(S / 64), dim3(64), 0, stream, QA + hd * 96, 768, KV + hd * 128, 1024, H + C_KR, INC, KV + hd * 128 + 64, 1024,
                                   OA + hd * 64, 512, 1.0f / sqrtf(96.f), S);
            for (int hd = 0; hd < 4; ++hd)
                for (int mp = 0; mp < 2; ++mp)
                    hipLaunchKernelGGL((attn_naive<64, 0, 128>), dim3(S / 64), dim3(64), 0, stream, H + C_QD + (hd * 2 + mp) * 64, INC, H + C_KD + (hd * 2 + mp) * 64, INC, (const float*)nullptr, 0,
                                       H + C_VD + hd * 128, INC, (mp == 0 ? OB1 : OB2) + hd * 128, 512, 0.125f, S);
            hipLaunchKernelGGL(mul_silu, dim3(S * 512 / 256), dim3(256), 0, stream, OA, H, C_GA, YAIN, S);
            hipLaunchKernelGGL(diff_combine, dim3(S * 4), dim3(64), 0, stream, OB1, OB2, dlam + l * 256, g_diff + l * 128, H, lam_init, YBIN);
            gemm(YAIN, 512, w_ba + (size_t)l * 512 * D, D, YA, D, S, D, 512);
            gemm(YBIN, 512, w_bb + (size_t)l * 512 * D, D, YB, D, S, D, 512);
            hipLaunchKernelGGL(merge_k, dim3(S * 1024 / 256), dim3(256), 0, stream, YA, YB, H, b_merge + l * 2048, MRG, S);
            gemm(MRG, D, w_out + (size_t)l * D * D, D, OUT, D, S, D, D);
            hipLaunchKernelGGL(ln_res, dim3(S), dim3(256), 0, stream, xin, OUT, ln_g + l * D, ln_b + l * D, xout);
        }
    }
}
```
